# Optimizing an MI355X kernel written in HIP

```python
import jax, jax.numpy as jnp
from jax import lax
import numpy as np

D_MODEL = 1024
BATCH = 8
SEQ = 4096
DEPTH = 1

POOL_WIDTH = D_MODEL
POOL_WINDOWS = (2, 4, 8, 16)
N_POOL_GROUPS = len(POOL_WINDOWS)
POOL_GROUP_DIM = POOL_WIDTH // N_POOL_GROUPS
CONV_WIDTH = D_MODEL
CONV_KERNEL = 31
N_BRANCHES = 2
D_IN = POOL_WIDTH + 2 * CONV_WIDTH + N_BRANCHES * D_MODEL
D_FF = ((8 * D_MODEL // 3 + 255) // 256) * 256
LN_EPS = 1e-5
DEEPNORM_ALPHA = (2.0 * DEPTH) ** 0.25
DEEPNORM_BETA = (8.0 * DEPTH) ** -0.25

kernel_name = "hybrid_pool_conformer_gated_deepnorm"


def layer_norm(x, g, b):
    xf = x.astype(jnp.float32)
    mu = jnp.mean(xf, axis=-1, keepdims=True)
    var = jnp.mean(jnp.square(xf - mu), axis=-1, keepdims=True)
    y = (xf - mu) * lax.rsqrt(var + LN_EPS)
    return (y * g.astype(jnp.float32) + b.astype(jnp.float32)).astype(x.dtype)


def multiscale_pool(xp):
    B, S, _ = xp.shape
    xg = xp.astype(jnp.float32).reshape(B, S, N_POOL_GROUPS, POOL_GROUP_DIM)
    cs = jnp.concatenate([jnp.zeros((B, 1, N_POOL_GROUPS, POOL_GROUP_DIM), jnp.float32),
                          jnp.cumsum(xg, axis=1)], axis=1)
    t = jnp.arange(S, dtype=jnp.int32)
    outs = []
    for g, w in enumerate(POOL_WINDOWS):
        lo = jnp.clip(t - w // 2, 0, S)
        hi = jnp.clip(t + w // 2, 0, S)
        cnt = (hi - lo).astype(jnp.float32)
        window_sum = cs[:, hi, g] - cs[:, lo, g]
        outs.append(window_sum / cnt[None, :, None] - xg[:, :, g])
    return jnp.stack(outs, axis=2).astype(xp.dtype)


def depthwise_conv(h, w, b):
    pad = (CONV_KERNEL - 1) // 2
    y = lax.conv_general_dilated(
        h, w[:, None, :].astype(h.dtype), window_strides=(1,), padding=[(pad, pad)],
        dimension_numbers=("NWC", "WIO", "NWC"), feature_group_count=h.shape[-1])
    return y + b


def setup_inputs(seed: int = 0) -> dict:
    key = jax.random.key(seed)
    ks = jax.random.split(key, 20)
    L = DEPTH
    nrm = lambda k, shape, s: jax.random.normal(k, shape, jnp.float32) * s
    return {
        "x": jax.random.normal(ks[0], (BATCH, SEQ, D_MODEL), jnp.float32),
        "w_in": nrm(ks[1], (L, D_MODEL, D_IN), D_MODEL ** -0.5),
        "b_in": nrm(ks[2], (L, D_IN), 0.02),
        "pool_w": nrm(ks[3], (L, N_POOL_GROUPS, POOL_GROUP_DIM, POOL_GROUP_DIM), POOL_GROUP_DIM ** -0.5),
        "pool_scale": 1.0 + nrm(ks[4], (L, POOL_WIDTH), 0.02),
        "w_pool_proj": nrm(ks[5], (L, POOL_WIDTH, D_MODEL), POOL_WIDTH ** -0.5),
        "conv_w": nrm(ks[6], (L, CONV_KERNEL, CONV_WIDTH), CONV_KERNEL ** -0.5),
        "conv_b": nrm(ks[7], (L, CONV_WIDTH), 0.02),
        "conv_ln_g": 1.0 + nrm(ks[8], (L, CONV_WIDTH), 0.02),
        "conv_ln_b": nrm(ks[9], (L, CONV_WIDTH), 0.02),
        "w_conv_proj": nrm(ks[10], (L, CONV_WIDTH, D_MODEL), CONV_WIDTH ** -0.5),
        "w_out": nrm(ks[11], (L, D_MODEL, D_MODEL), D_MODEL ** -0.5 * DEEPNORM_BETA),
        "ln1_g": 1.0 + nrm(ks[12], (L, D_MODEL), 0.02),
        "ln1_b": nrm(ks[13], (L, D_MODEL), 0.02),
        "w_ffn_in": nrm(ks[14], (L, D_MODEL, 2 * D_FF), D_MODEL ** -0.5),
        "w_ffn_down": nrm(ks[15], (L, D_FF, D_MODEL), D_FF ** -0.5 * DEEPNORM_BETA),
        "ln2_g": 1.0 + nrm(ks[16], (L, D_MODEL), 0.02),
        "ln2_b": nrm(ks[17], (L, D_MODEL), 0.02),
    }


def reference(x, w_in, b_in, pool_w, pool_scale, w_pool_proj, conv_w, conv_b,
              conv_ln_g, conv_ln_b, w_conv_proj, w_out, ln1_g, ln1_b,
              w_ffn_in, w_ffn_down, ln2_g, ln2_b):
    B, S, _ = x.shape
    for l in range(DEPTH):
        u = jnp.einsum("bsd,de->bse", x, w_in[l]) + b_in[l]
        u_pool = u[..., :POOL_WIDTH]
        u_conv = u[..., POOL_WIDTH:POOL_WIDTH + 2 * CONV_WIDTH]
        u_gate = u[..., POOL_WIDTH + 2 * CONV_WIDTH:]
        gate_pool = jax.nn.sigmoid(u_gate[..., :D_MODEL])
        gate_conv = jax.nn.sigmoid(u_gate[..., D_MODEL:])

        pooled = multiscale_pool(u_pool)
        pooled = jnp.einsum("bsgc,gce->bsge", pooled, pool_w[l]).reshape(B, S, POOL_WIDTH)
        y_pool = jnp.einsum("bsp,pd->bsd", pooled * pool_scale[l], w_pool_proj[l])

        h = u_conv[..., :CONV_WIDTH] * jax.nn.sigmoid(u_conv[..., CONV_WIDTH:])
        h = depthwise_conv(h, conv_w[l], conv_b[l])
        h = jax.nn.silu(layer_norm(h, conv_ln_g[l], conv_ln_b[l]))
        y_conv = jnp.einsum("bsc,cd->bsd", h, w_conv_proj[l])

        merged = gate_pool * y_pool + gate_conv * y_conv
        mix_out = jnp.einsum("bsd,de->bse", merged, w_out[l])
        x = layer_norm(DEEPNORM_ALPHA * x + mix_out, ln1_g[l], ln1_b[l])

        gu = jnp.einsum("bsd,df->bsf", x, w_ffn_in[l])
        hid = jax.nn.silu(gu[..., :D_FF]) * gu[..., D_FF:]
        ffn_out = jnp.einsum("bsf,fd->bsd", hid, w_ffn_down[l])
        x = layer_norm(DEEPNORM_ALPHA * x + ffn_out, ln2_g[l], ln2_b[l])
    return x
```

```cpp
#include <hip/hip_runtime.h>
#include <hip/hip_cooperative_groups.h>
#include <cstdio>
#include <cstdint>
namespace cg = cooperative_groups;

#ifndef MK_PER_PHASE
#define MK_PER_PHASE 1
#endif

#define LAS __attribute__((address_space(3)))
typedef unsigned short bf16_t;
typedef short bf16x8 __attribute__((ext_vector_type(8)));
typedef float f32x4 __attribute__((ext_vector_type(4)));
typedef float f32x2 __attribute__((ext_vector_type(2)));
typedef unsigned u32x4 __attribute__((ext_vector_type(4)));
typedef unsigned u32x2 __attribute__((ext_vector_type(2)));

constexpr int BATCH = 8, SEQ = 4096, D = 1024, M = BATCH * SEQ, DIN = 5120, FF = 2816, CK = 31;
constexpr float LN_EPS = 1e-5f;
constexpr float ALPHA = 1.189207115002721f;
constexpr int NWAVES = 8;
constexpr int N_PHASES = 10;

constexpr size_t MiB = 1u << 20;
constexpr size_t WS_BIASP = 1 * MiB;
constexpr size_t WS_WIN = 2 * MiB;
constexpr size_t WS_PW = 12 * MiB;
constexpr size_t WS_WPP = 13 * MiB;
constexpr size_t WS_WCP = 15 * MiB;
constexpr size_t WS_WO = 17 * MiB;
constexpr size_t WS_WF1 = 19 * MiB;
constexpr size_t WS_WF2 = 30 * MiB;
constexpr size_t WS_XB = 40 * MiB;
constexpr size_t WS_PL = 40 * MiB;
constexpr size_t WS_UP = 104 * MiB;
constexpr size_t WS_P2 = 104 * MiB;
constexpr size_t WS_H = 168 * MiB;
constexpr size_t WS_MG = 168 * MiB;
constexpr size_t WS_GP = 232 * MiB;
constexpr size_t WS_GC = 296 * MiB;
constexpr size_t WS_HC = 360 * MiB;
constexpr size_t WS_Z1 = 40 * MiB;
constexpr size_t WS_X1B = 232 * MiB;
constexpr size_t WS_HID = 296 * MiB;
constexpr size_t WS_END = 472 * MiB;

constexpr int LDS_BYTES = 147456;

#define LDS_WAIT() asm volatile("s_waitcnt lgkmcnt(0)" ::: "memory")
__device__ __forceinline__ unsigned cvt_pk_bf16(float lo, float hi) { unsigned r; asm volatile("v_cvt_pk_bf16_f32 %0, %1, %2" : "=v"(r) : "v"(lo), "v"(hi)); return r; }
__device__ __forceinline__ float bf_lo(unsigned w) { return __uint_as_float(w << 16); }
__device__ __forceinline__ float bf_hi(unsigned w) { return __uint_as_float(w & 0xffff0000u); }
__device__ __forceinline__ float sigmoidf_fast(float v) { return __builtin_amdgcn_rcpf(1.0f + __builtin_amdgcn_exp2f(v * -1.4426950408889634f)); }
__device__ __forceinline__ float wave_sum(float v) {
#pragma unroll
    for (int o = 1; o < 64; o <<= 1) v += __shfl_xor(v, o);
    return v;
}

namespace pg8 {
constexpr int BM = 256, BK = 64, HALF = 128, HTB = HALF * BK * 2, STAGE_BYTES = 8 * HTB, NXCD = 8, WGM = 8;
__host__ __device__ __forceinline__ int lds_byte(int r, int c) { const int st = (r >> 4) * 2 + (c >> 5), rr = r & 15, cc = c & 31, ob = rr * 64 + cc * 2; return st * 1024 + (ob ^ (((ob >> 9) & 1) << 5)); }
__host__ __device__ __forceinline__ void stage_rc(int b, int& R, int& C) { const int st = b / 1024, sb = b % 1024, swz = sb ^ (((sb >> 9) & 1) << 5); R = (st >> 1) * 16 + swz / 64; C = (st & 1) * 32 + (swz % 64) / 2; }
__host__ __device__ __forceinline__ int perm32(int rho) { const int n = rho >> 4, i = rho & 15; return 8 * (i >> 2) + 4 * n + (i & 3); }

struct Unit { int pm, pn, z; };
struct Gemm { const bf16_t* A0; const bf16_t* A1; const bf16_t* B0; const bf16_t* B1; int lda, ldb, K, a_pn_off; };

struct Order {
    int nM, nN, nwg, G, c, zn;
    __device__ void init(int M_, int N_, int G_, int c_, int zn_) { nM = M_ / BM; nN = N_ / BM; nwg = nM * nN; G = G_; c = c_; zn = zn_; }
    __device__ bool next(int i, Unit& u) const {
        const int j = i / zn; u.z = i - j * zn;
        const long L = (long)j * G + c; if (L >= nwg) return false;
        int wgid = (int)L; { const int q = nwg / NXCD, r = nwg % NXCD, xcd = wgid % NXCD, off = wgid / NXCD; wgid = (xcd < r ? xcd * (q + 1) : r * (q + 1) + (xcd - r) * q) + off; }
        const int nig = WGM * nN, gid = wgid / nig, fm = gid * WGM, gsz = (nM - fm) < WGM ? (nM - fm) : WGM;
        u.pm = fm + ((wgid % nig) % gsz); u.pn = (wgid % nig) / gsz; return true;
    }
};

typedef f32x4 Acc[2][2][4][2];

__device__ __forceinline__ u32x4 pack8(const f32x4 v0, const f32x4 v1) { u32x4 w; w.x = cvt_pk_bf16(v0[0], v0[1]); w.y = cvt_pk_bf16(v0[2], v0[3]); w.z = cvt_pk_bf16(v1[0], v1[1]); w.w = cvt_pk_bf16(v1[2], v1[3]); return w; }
__device__ __forceinline__ f32x4 sig4(f32x4 v) { return (f32x4){sigmoidf_fast(v[0]), sigmoidf_fast(v[1]), sigmoidf_fast(v[2]), sigmoidf_fast(v[3])}; }

struct EpiG1 {
    static constexpr bool PERM = true;
    bf16_t *UP, *H, *GP, *GC; const float* biasp;
    __device__ __forceinline__ bool keep(const Unit&) const { return false; }
    __device__ __forceinline__ void operator()(Acc& acc, const Unit& u, int wr, int wc, int fr, int fq) const {
        const int row0 = u.pm * BM + wr * 64 + fr, lc = wc * 32 + 8 * fq;
        f32x4 bv[2][2];
#pragma unroll
        for (int bj = 0; bj < 2; ++bj)
#pragma unroll
            for (int n = 0; n < 2; ++n) bv[bj][n] = *(const f32x4*)(biasp + u.pn * BM + bj * HALF + lc + 4 * n);
        if (u.pn >= 4 && u.pn < 12) {
            bf16_t* base = H + (u.pn - 4) * HALF + lc;
#pragma unroll
            for (int ai = 0; ai < 2; ++ai)
#pragma unroll
                for (int m = 0; m < 4; ++m) {
                    const f32x4 a0 = acc[ai][0][m][0] + bv[0][0], a1 = acc[ai][0][m][1] + bv[0][1];
                    const f32x4 b0 = sig4(acc[ai][1][m][0] + bv[1][0]), b1 = sig4(acc[ai][1][m][1] + bv[1][1]);
                    *(u32x4*)(base + (size_t)(row0 + ai * HALF + m * 16) * D) = pack8(a0 * b0, a1 * b1);
                }
        } else {
            bf16_t* base = (u.pn < 4 ? UP + u.pn * BM : (u.pn < 16 ? GP + (u.pn - 12) * BM : GC + (u.pn - 16) * BM)) + lc;
            const bool act = u.pn >= 12;
#pragma unroll
            for (int ai = 0; ai < 2; ++ai)
#pragma unroll
                for (int m = 0; m < 4; ++m)
#pragma unroll
                    for (int bj = 0; bj < 2; ++bj) {
                        f32x4 v0 = acc[ai][bj][m][0] + bv[bj][0], v1 = acc[ai][bj][m][1] + bv[bj][1];
                        if (act) { v0 = sig4(v0); v1 = sig4(v1); }
                        *(u32x4*)(base + (size_t)(row0 + ai * HALF + m * 16) * D + bj * HALF) = pack8(v0, v1);
                    }
        }
    }
};
struct EpiG2a {
    static constexpr bool PERM = true;
    bf16_t* P2; const float* scale;
    __device__ __forceinline__ bool keep(const Unit&) const { return false; }
    __device__ __forceinline__ void operator()(Acc& acc, const Unit& u, int wr, int wc, int fr, int fq) const {
        const int row0 = u.pm * BM + wr * 64 + fr, col0 = u.pn * BM + wc * 32 + 8 * fq;
        f32x4 sv[2][2];
#pragma unroll
        for (int bj = 0; bj < 2; ++bj)
#pragma unroll
            for (int n = 0; n < 2; ++n) sv[bj][n] = *(const f32x4*)(scale + col0 + bj * HALF + 4 * n);
#pragma unroll
        for (int ai = 0; ai < 2; ++ai)
#pragma unroll
            for (int m = 0; m < 4; ++m)
#pragma unroll
                for (int bj = 0; bj < 2; ++bj)
                    *(u32x4*)(P2 + (size_t)(row0 + ai * HALF + m * 16) * D + col0 + bj * HALF) = pack8(acc[ai][bj][m][0] * sv[bj][0], acc[ai][bj][m][1] * sv[bj][1]);
    }
};
struct EpiG2b {
    static constexpr bool PERM = true;
    const bf16_t *GP, *GC; bf16_t* MG;
    __device__ __forceinline__ bool keep(const Unit& u) const { return u.z == 0; }
    __device__ __forceinline__ void operator()(Acc& acc, const Unit& u, int wr, int wc, int fr, int fq) const {
        const int row0 = u.pm * BM + wr * 64 + fr, col0 = u.pn * BM + wc * 32 + 8 * fq;
        if (u.z == 0) {
#pragma unroll
            for (int ai = 0; ai < 2; ++ai)
#pragma unroll
                for (int m = 0; m < 4; ++m)
#pragma unroll
                    for (int bj = 0; bj < 2; ++bj) {
                        const size_t off = (size_t)(row0 + ai * HALF + m * 16) * D + col0 + bj * HALF;
                        const u32x4 p = *(const u32x4*)(GP + off), c = *(const u32x4*)(GC + off);
                        f32x4 r0, r1;
                        r0[0] = bf_lo(p.x) * __builtin_amdgcn_rcpf(bf_lo(c.x)); r0[1] = bf_hi(p.x) * __builtin_amdgcn_rcpf(bf_hi(c.x));
                        r0[2] = bf_lo(p.y) * __builtin_amdgcn_rcpf(bf_lo(c.y)); r0[3] = bf_hi(p.y) * __builtin_amdgcn_rcpf(bf_hi(c.y));
                        r1[0] = bf_lo(p.z) * __builtin_amdgcn_rcpf(bf_lo(c.z)); r1[1] = bf_hi(p.z) * __builtin_amdgcn_rcpf(bf_hi(c.z));
                        r1[2] = bf_lo(p.w) * __builtin_amdgcn_rcpf(bf_lo(c.w)); r1[3] = bf_hi(p.w) * __builtin_amdgcn_rcpf(bf_hi(c.w));
                        acc[ai][bj][m][0] *= r0; acc[ai][bj][m][1] *= r1;
                    }
        } else {
#pragma unroll
            for (int ai = 0; ai < 2; ++ai)
#pragma unroll
                for (int m = 0; m < 4; ++m)
#pragma unroll
                    for (int bj = 0; bj < 2; ++bj) {
                        const size_t off = (size_t)(row0 + ai * HALF + m * 16) * D + col0 + bj * HALF;
                        const u32x4 c = *(const u32x4*)(GC + off);
                        const f32x4 g0 = {bf_lo(c.x), bf_hi(c.x), bf_lo(c.y), bf_hi(c.y)}, g1 = {bf_lo(c.z), bf_hi(c.z), bf_lo(c.w), bf_hi(c.w)};
                        *(u32x4*)(MG + off) = pack8(acc[ai][bj][m][0] * g0, acc[ai][bj][m][1] * g1);
                    }
        }
    }
};
struct EpiRes {
    static constexpr bool PERM = false;
    const float* base; float* out;
    __device__ __forceinline__ bool keep(const Unit&) const { return false; }
    __device__ __forceinline__ void operator()(Acc& acc, const Unit& u, int wr, int wc, int fr, int fq) const {
        const int row0 = u.pm * BM + wr * 64 + fr, col0 = u.pn * BM + wc * 32 + 4 * fq;
#pragma unroll
        for (int ai = 0; ai < 2; ++ai)
#pragma unroll
            for (int m = 0; m < 4; ++m)
#pragma unroll
                for (int bj = 0; bj < 2; ++bj)
#pragma unroll
                    for (int n = 0; n < 2; ++n) {
                        const size_t off = (size_t)(row0 + ai * HALF + m * 16) * D + col0 + bj * HALF + n * 16;
                        const f32x4 b = *(const f32x4*)(base + off);
                        *(f32x4*)(out + off) = b * ALPHA + acc[ai][bj][m][n];
                    }
    }
};
struct EpiG4 {
    static constexpr bool PERM = true;
    bf16_t* HID;
    __device__ __forceinline__ bool keep(const Unit&) const { return false; }
    __device__ __forceinline__ void operator()(Acc& acc, const Unit& u, int wr, int wc, int fr, int fq) const {
        const int row0 = u.pm * BM + wr * 64 + fr;
        bf16_t* base = HID + u.pn * HALF + wc * 32 + 8 * fq;
#pragma unroll
        for (int ai = 0; ai < 2; ++ai)
#pragma unroll
            for (int m = 0; m < 4; ++m) {
                const f32x4 g0 = acc[ai][0][m][0], g1 = acc[ai][0][m][1];
                const f32x4 h0 = g0 * sig4(g0) * acc[ai][1][m][0], h1 = g1 * sig4(g1) * acc[ai][1][m][1];
                *(u32x4*)(base + (size_t)(row0 + ai * HALF + m * 16) * FF) = pack8(h0, h1);
            }
    }
};

template <class Epi, bool ALIGN_EPI = true>
__device__ __forceinline__ void gemm_phase(LAS unsigned char* lds, const Gemm g, const Order& S, const Epi& E) {
    const int tid = threadIdx.x, wid = __builtin_amdgcn_readfirstlane(tid >> 6), lane = tid & 63, wr = wid >> 2, wc = wid & 3, fr = lane & 15, fq = lane >> 4;
    const int K = g.K, nt = K / BK;
    unsigned voffA[2], voffB[2];
#pragma unroll
    for (int i = 0; i < 2; ++i) { int R, C; stage_rc(tid * 16 + i * 8192, R, C); const int Rb = Epi::PERM ? ((R & ~31) + perm32(R & 31)) : R;
        voffA[i] = (unsigned)(R * g.lda + C) * 2u; voffB[i] = (unsigned)(Rb * g.ldb + C) * 2u; }
    const size_t kstep = (size_t)(BK * 2);
    const size_t hstepA = (size_t)HALF * g.lda * 2, hstepB = (size_t)HALF * g.ldb * 2;
    const unsigned ldsw = (unsigned)wid * 1024u;
    const int aoff = lds_byte(wr * 64 + fr, fq * 8), boff = lds_byte(wc * 32 + fr, fq * 8);
#define PG8_SA(b, h) (((b) * 2 + (h)) * HTB)
#define PG8_SB(b, h) ((4 + (b) * 2 + (h)) * HTB)
#define PG8_STAGE(bufoff, gbase, voff) do { _Pragma("unroll") for (int _i = 0; _i < 2; ++_i) \
        __builtin_amdgcn_global_load_lds((const unsigned*)((const char*)(gbase) + (voff)[_i]), (LAS unsigned*)(lds + (bufoff) + ldsw + _i * 8192), 16, 0, 0); } while (0)
#define PG8_LDA(dst, b, h) do { _Pragma("unroll") for (int m = 0; m < 4; ++m) _Pragma("unroll") for (int k = 0; k < 2; ++k) dst[m][k] = *(const LAS bf16x8*)(lds + PG8_SA(b, h) + aoff + m * 2048 + k * 1024); } while (0)
#define PG8_LDB(dst, b, h) do { _Pragma("unroll") for (int n = 0; n < 2; ++n) _Pragma("unroll") for (int k = 0; k < 2; ++k) dst[n][k] = *(const LAS bf16x8*)(lds + PG8_SB(b, h) + boff + n * 2048 + k * 1024); } while (0)
#define PG8_MMA(ai, bj, At, Bt) do { __builtin_amdgcn_s_setprio(1); _Pragma("unroll") for (int m = 0; m < 4; ++m) _Pragma("unroll") for (int n = 0; n < 2; ++n) _Pragma("unroll") for (int k = 0; k < 2; ++k) \
        acc[ai][bj][m][n] = __builtin_amdgcn_mfma_f32_16x16x32_bf16(Bt[n][k], At[m][k], acc[ai][bj][m][n], 0, 0, 0); __builtin_amdgcn_s_setprio(0); } while (0)
#define PG8_WAIT_V(n) asm volatile("s_waitcnt vmcnt(" #n ")" ::: "memory")
#define PG8_WAIT_L(n) asm volatile("s_waitcnt lgkmcnt(" #n ")" ::: "memory")
#define PG8_BAR __builtin_amdgcn_s_barrier()
#define PG8_SCHED __builtin_amdgcn_sched_barrier(0)
#define PG8_ABASE(u) ((const char*)((u).z ? g.A1 : g.A0) + ((size_t)(u).pm * BM * g.lda + (size_t)(u).pn * g.a_pn_off) * 2)
#define PG8_BBASE(u) ((const char*)((u).z ? g.B1 : g.B0) + ((size_t)(u).pn * BM * g.ldb) * 2)
    Unit cur, nxt; int ui = 0;
    if (!S.next(0, cur)) return;
    Acc acc;
#pragma unroll
    for (int a = 0; a < 2; ++a)
#pragma unroll
        for (int b = 0; b < 2; ++b)
#pragma unroll
            for (int m = 0; m < 4; ++m)
#pragma unroll
                for (int n = 0; n < 2; ++n) acc[a][b][m][n] = (f32x4){0.f, 0.f, 0.f, 0.f};
    bf16x8 At[4][2], B0[2][2], B1[2][2];
    const char* cA = PG8_ABASE(cur); const char* cB = PG8_BBASE(cur);
    PG8_STAGE(PG8_SB(0, 0), cB, voffB); PG8_STAGE(PG8_SB(0, 1), cB + hstepB, voffB); PG8_STAGE(PG8_SA(0, 0), cA, voffA); PG8_STAGE(PG8_SA(0, 1), cA + hstepA, voffA);
    if (wr == 1) PG8_BAR;
    PG8_WAIT_V(2); PG8_BAR;
    PG8_STAGE(PG8_SB(1, 0), cB + kstep, voffB); PG8_STAGE(PG8_SA(1, 0), cA + kstep, voffA); PG8_STAGE(PG8_SB(1, 1), cB + hstepB + kstep, voffB);
    PG8_WAIT_V(6); PG8_BAR;
    for (;;) {
        const bool has_next = S.next(ui + 1, nxt);
        const char* nA = has_next ? PG8_ABASE(nxt) : cA; const char* nB = has_next ? PG8_BBASE(nxt) : cB;
#pragma unroll 1
        for (int t = 0; t < nt; t += 2) {
            const bool last = (t == nt - 2);
            const char* a1 = cA + (size_t)(t + 1) * kstep;
            const char* a2 = last ? nA : cA + (size_t)(t + 2) * kstep; const char* b2 = last ? nB : cB + (size_t)(t + 2) * kstep;
            const char* a3 = a2 + kstep; const char* b3 = b2 + kstep;
            PG8_LDB(B0, 0, 0); PG8_LDB(B1, 0, 1); PG8_SCHED; PG8_LDA(At, 0, 0); PG8_STAGE(PG8_SA(1, 1), a1 + hstepA, voffA);
            PG8_WAIT_V(8); PG8_WAIT_L(0); PG8_BAR; PG8_MMA(0, 0, At, B0); PG8_MMA(0, 1, At, B1); PG8_BAR; PG8_SCHED;
            PG8_LDA(At, 0, 1); PG8_STAGE(PG8_SB(0, 0), b2, voffB); PG8_STAGE(PG8_SB(0, 1), b2 + hstepB, voffB); PG8_STAGE(PG8_SA(0, 0), a2, voffA);
            PG8_WAIT_V(8); PG8_WAIT_L(0); PG8_BAR; PG8_MMA(1, 0, At, B0); PG8_MMA(1, 1, At, B1); PG8_BAR; PG8_SCHED;
            PG8_LDB(B0, 1, 0); PG8_LDB(B1, 1, 1); PG8_SCHED; PG8_LDA(At, 1, 0); PG8_STAGE(PG8_SA(0, 1), a2 + hstepA, voffA);
            PG8_WAIT_V(8); PG8_WAIT_L(0); PG8_BAR; PG8_MMA(0, 0, At, B0); PG8_MMA(0, 1, At, B1); PG8_BAR; PG8_SCHED;
            PG8_LDA(At, 1, 1); PG8_STAGE(PG8_SB(1, 0), b3, voffB); PG8_STAGE(PG8_SB(1, 1), b3 + hstepB, voffB); PG8_STAGE(PG8_SA(1, 0), a3, voffA);
            PG8_WAIT_V(8); PG8_WAIT_L(0); PG8_BAR; PG8_MMA(1, 0, At, B0); PG8_MMA(1, 1, At, B1); PG8_BAR; PG8_SCHED;
        }
        if constexpr (ALIGN_EPI) { if (wr == 0) PG8_BAR; }
        E(acc, cur, wr, wc, fr, fq);
        if (!has_next) break;
        if (!E.keep(cur)) {
#pragma unroll
            for (int a = 0; a < 2; ++a)
#pragma unroll
                for (int b = 0; b < 2; ++b)
#pragma unroll
                    for (int m = 0; m < 4; ++m)
#pragma unroll
                        for (int n = 0; n < 2; ++n) acc[a][b][m][n] = (f32x4){0.f, 0.f, 0.f, 0.f};
        }
        cur = nxt; cA = nA; cB = nB; ++ui;
        if constexpr (ALIGN_EPI) { if (wr == 1) PG8_BAR; }
    }
    PG8_WAIT_V(0);
    if constexpr (!ALIGN_EPI) { if (wr == 0) PG8_BAR; }
    PG8_BAR;
#undef PG8_SA
#undef PG8_SB
#undef PG8_STAGE
#undef PG8_LDA
#undef PG8_LDB
#undef PG8_MMA
#undef PG8_WAIT_V
#undef PG8_WAIT_L
#undef PG8_BAR
#undef PG8_SCHED
#undef PG8_ABASE
#undef PG8_BBASE
}
}

struct Frame {
    LAS unsigned char* lds;
    int tid, lane, wave, G;
};

__device__ __forceinline__ unsigned f2bf(float f) { unsigned u = __builtin_bit_cast(unsigned, f); return (u + 0x7fffu + ((u >> 16) & 1u)) >> 16; }
__device__ __forceinline__ unsigned pk2(float lo, float hi) { return f2bf(lo) | (f2bf(hi) << 16); }

__device__ __forceinline__ void p0_transpose_item(const float* W, int K, int N, bf16_t* WT, int dst_row0, int src_n0, int k0, LAS float* scr, int lane) {
#pragma unroll 8
    for (int i = 0; i < 32; ++i) { const int kk = 2 * i + (lane >> 5); scr[kk * 33 + (lane & 31)] = W[(size_t)(k0 + kk) * N + src_n0 + (lane & 31)]; }
    LDS_WAIT(); asm volatile("" ::: "memory");
    const int c = lane & 7;
#pragma unroll
    for (int j = 0; j < 4; ++j) { const int n = (lane >> 3) + 8 * j; const LAS float* s = scr + (8 * c) * 33 + n;
        u32x4 o; o.x = pk2(s[0 * 33], s[1 * 33]); o.y = pk2(s[2 * 33], s[3 * 33]); o.z = pk2(s[4 * 33], s[5 * 33]); o.w = pk2(s[6 * 33], s[7 * 33]);
        *(u32x4*)(WT + (size_t)(dst_row0 + n) * K + k0 + 8 * c) = o; }
    LDS_WAIT(); asm volatile("" ::: "memory");
}
__device__ __forceinline__ int win_src(int np) {
    const int t = np >> 8, l = np & 255;
    if (t >= 4 && t < 12) { const int j = t - 4; return (l < 128) ? (1024 + 128 * j + l) : (2048 + 128 * j + (l - 128)); }
    return np;
}
__device__ __forceinline__ int wf1_src(int np) {
    const int j = np >> 8, l = np & 255;
    return (l < 128) ? (128 * j + l) : (FF + 128 * j + (l - 128));
}

struct Args { const float* in[18]; float* out; unsigned char* ws; int ph_lo, ph_hi; };
#define WSP(T, off) ((T*)(args.ws + (off)))
__device__ __forceinline__ void p0_prologue(Frame& F, const Args& args) {
    LAS float* scr = (LAS float*)(F.lds + F.wave * 16384);
    const int gw = blockIdx.x * NWAVES + F.wave, NGW = F.G * NWAVES;
    constexpr int I_IN = (D / 64) * (DIN / 32), I_PW = 4 * (256 / 64) * (256 / 32), I_SQ = (D / 64) * (D / 32), I_F1 = (D / 64) * (2 * FF / 32), I_F2 = (FF / 64) * (D / 32);
    constexpr int NITEMS = I_IN + I_PW + 3 * I_SQ + I_F1 + I_F2;
    for (int it = gw; it < NITEMS; it += NGW) {
        int r = it;
        if (r < I_IN) { const int nblk = DIN / 32, kb = r / nblk, nb = r % nblk; p0_transpose_item(args.in[1], D, DIN, WSP(bf16_t, WS_WIN), 32 * nb, win_src(32 * nb), 64 * kb, scr, F.lane); continue; } r -= I_IN;
        if (r < I_PW) { const int g = r / 32, rr = r % 32, kb = rr / 8, nb = rr % 8; p0_transpose_item(args.in[3] + (size_t)g * 65536, 256, 256, WSP(bf16_t, WS_PW), g * 256 + 32 * nb, 32 * nb, 64 * kb, scr, F.lane); continue; } r -= I_PW;
        if (r < I_SQ) { const int nblk = D / 32, kb = r / nblk, nb = r % nblk; p0_transpose_item(args.in[5], D, D, WSP(bf16_t, WS_WPP), 32 * nb, 32 * nb, 64 * kb, scr, F.lane); continue; } r -= I_SQ;
        if (r < I_SQ) { const int nblk = D / 32, kb = r / nblk, nb = r % nblk; p0_transpose_item(args.in[10], D, D, WSP(bf16_t, WS_WCP), 32 * nb, 32 * nb, 64 * kb, scr, F.lane); continue; } r -= I_SQ;
        if (r < I_SQ) { const int nblk = D / 32, kb = r / nblk, nb = r % nblk; p0_transpose_item(args.in[11], D, D, WSP(bf16_t, WS_WO), 32 * nb, 32 * nb, 64 * kb, scr, F.lane); continue; } r -= I_SQ;
        if (r < I_F1) { const int nblk = 2 * FF / 32, kb = r / nblk, nb = r % nblk; p0_transpose_item(args.in[14], D, 2 * FF, WSP(bf16_t, WS_WF1), 32 * nb, wf1_src(32 * nb), 64 * kb, scr, F.lane); continue; } r -= I_F1;
        { const int nblk = D / 32, kb = r / nblk, nb = r % nblk; p0_transpose_item(args.in[15], FF, D, WSP(bf16_t, WS_WF2), 32 * nb, 32 * nb, 64 * kb, scr, F.lane); }
    }
    { float* biasp = WSP(float, WS_BIASP); const float* b_in = args.in[2];
      for (int i = blockIdx.x * 512 + F.tid; i < DIN; i += F.G * 512) biasp[i] = b_in[win_src(i)]; }
    const float* x = args.in[0]; bf16_t* XB = WSP(bf16_t, WS_XB);
    for (int m = gw; m < M; m += NGW) {
        const f32x4* xr = (const f32x4*)(x + (size_t)m * D) + F.lane; u32x2* o8 = (u32x2*)(XB + (size_t)m * D) + F.lane;
#pragma unroll
        for (int j = 0; j < 4; ++j) { const f32x4 v = xr[64 * j]; u32x2 w; w.x = cvt_pk_bf16(v.x, v.y); w.y = cvt_pk_bf16(v.z, v.w); o8[64 * j] = w; }
    }
}

__device__ __forceinline__ void ln_rows(Frame& F, const float* in, float* outf, bf16_t* outb, const float* g, const float* b) {
    const int gw = blockIdx.x * NWAVES + F.wave, NGW = F.G * NWAVES;
    f32x4 gv[4], bv[4];
#pragma unroll
    for (int j = 0; j < 4; ++j) { gv[j] = ((const f32x4*)g)[F.lane + 64 * j]; bv[j] = ((const f32x4*)b)[F.lane + 64 * j]; }
    for (int m = gw; m < M; m += NGW) {
        const f32x4* xr = (const f32x4*)(in + (size_t)m * D) + F.lane;
        f32x4 v[4]; float s = 0.f;
#pragma unroll
        for (int j = 0; j < 4; ++j) { v[j] = xr[64 * j]; s += (v[j].x + v[j].y) + (v[j].z + v[j].w); }
        const float mean = wave_sum(s) * (1.f / D); float s2 = 0.f;
#pragma unroll
        for (int j = 0; j < 4; ++j) { v[j] = v[j] - mean; s2 += (v[j].x * v[j].x + v[j].y * v[j].y) + (v[j].z * v[j].z + v[j].w * v[j].w); }
        const float rstd = 1.f / sqrtf(wave_sum(s2) * (1.f / D) + LN_EPS);
#pragma unroll
        for (int j = 0; j < 4; ++j) {
            const f32x4 y = v[j] * rstd * gv[j] + bv[j];
            if (outf) ((f32x4*)(outf + (size_t)m * D))[F.lane + 64 * j] = y;
            if (outb) { u32x2 w; w.x = cvt_pk_bf16(y.x, y.y); w.y = cvt_pk_bf16(y.z, y.w); ((u32x2*)(outb + (size_t)m * D))[F.lane + 64 * j] = w; }
        }
    }
}

template <int HW>
__device__ __forceinline__ void pool_item(Frame& F, const bf16_t* UP, bf16_t* PL, int b, int t0) {
    const unsigned* Ub = (const unsigned*)UP + (size_t)b * SEQ * 512 + F.tid;
    unsigned* Pb = (unsigned*)PL + (size_t)b * SEQ * 512 + F.tid;
    constexpr int W = 8 + 2 * HW;
    f32x2 win[W];
#pragma unroll
    for (int i = 0; i < 8; ++i) win[i] = (f32x2){0.f, 0.f};
#pragma unroll
    for (int i = 8; i < W; ++i) { const int t = t0 - HW - 8 + i; unsigned w = 0u; if (t >= 0) w = Ub[(size_t)t * 512]; win[i] = (f32x2){bf_lo(w), bf_hi(w)}; }
#pragma unroll 1
    for (int blk = 0; blk < 8; ++blk) {
        const int tb0 = t0 + 8 * blk;
#pragma unroll
        for (int i = 0; i < W - 8; ++i) win[i] = win[i + 8];
#pragma unroll
        for (int i = W - 8; i < W; ++i) { const int t = tb0 - HW + i; unsigned w = 0u; if (t < SEQ) w = Ub[(size_t)t * 512]; win[i] = (f32x2){bf_lo(w), bf_hi(w)}; }
#pragma unroll
        for (int o = 0; o < 8; ++o) {
            f32x2 s = win[o];
#pragma unroll
            for (int j = 1; j < 2 * HW; ++j) s += win[o + j];
            const int t = tb0 + o; const int hi = (t + HW < SEQ) ? t + HW : SEQ, lo = (t - HW > 0) ? t - HW : 0;
            const float inv = 1.0f / (float)(hi - lo);
            const f32x2 r = s * inv - win[o + HW];
            Pb[(size_t)t * 512] = cvt_pk_bf16(r.x, r.y);
        }
    }
}

__device__ __forceinline__ void thin_item(Frame& F, const Args& args, int item) {
    const bf16_t* H = WSP(const bf16_t, WS_H); bf16_t* HC = WSP(bf16_t, WS_HC);
    const float *conv_w = args.in[6], *conv_b = args.in[7], *conv_ln_g = args.in[8], *conv_ln_b = args.in[9];
    const int b = item >> 6, t0 = (item & 63) * 64;
    const int tid = F.tid;
    {
        const unsigned* Hb = (const unsigned*)H + (size_t)b * SEQ * 512 + tid;
        f32x2 w[CK];
#pragma unroll
        for (int j = 0; j < CK; ++j) w[j] = *(const f32x2*)(conv_w + j * D + 2 * tid);
        const f32x2 cb = *(const f32x2*)(conv_b + 2 * tid);
        f32x4 lg[4], lb[4];
#pragma unroll
        for (int j = 0; j < 4; ++j) { lg[j] = ((const f32x4*)conv_ln_g)[F.lane + 64 * j]; lb[j] = ((const f32x4*)conv_ln_b)[F.lane + 64 * j]; }
        unsigned win[38];
#pragma unroll
        for (int i = 0; i < 8; ++i) win[i] = 0u;
#pragma unroll
        for (int i = 8; i < 38; ++i) { const int t = t0 - 23 + i; unsigned v = 0u; if (t >= 0) v = Hb[(size_t)t * 512]; win[i] = v; }
        LAS float* tile = (LAS float*)F.lds;
#pragma unroll 1
        for (int blk = 0; blk < 8; ++blk) {
            const int tb0 = t0 + 8 * blk;
#pragma unroll
            for (int i = 0; i < 30; ++i) win[i] = win[i + 8];
#pragma unroll
            for (int i = 30; i < 38; ++i) { const int t = tb0 - 15 + i; unsigned v = 0u; if (t < SEQ) v = Hb[(size_t)t * 512]; win[i] = v; }
            f32x2 acc[8];
#pragma unroll
            for (int o = 0; o < 8; ++o) acc[o] = cb;
#pragma unroll
            for (int i = 0; i < 38; ++i) {
                const f32x2 v = {bf_lo(win[i]), bf_hi(win[i])};
#pragma unroll
                for (int o = 0; o < 8; ++o) { const int j = i - o; if (j >= 0 && j < CK) acc[o] = __builtin_elementwise_fma(w[j], v, acc[o]); }
            }
            LAS float* tb = tile + (blk & 1) * 8192;
#pragma unroll
            for (int o = 0; o < 8; ++o) *(LAS f32x2*)(tb + o * 1024 + 2 * tid) = acc[o];
            LDS_WAIT(); __syncthreads();
            {
                f32x4 v[4]; float s = 0.f, q = 0.f;
#pragma unroll
                for (int j = 0; j < 4; ++j) { v[j] = *(const LAS f32x4*)(tb + F.wave * 1024 + 4 * F.lane + 256 * j); s += (v[j].x + v[j].y) + (v[j].z + v[j].w); }
                const float mean = wave_sum(s) * (1.f / D);
#pragma unroll
                for (int j = 0; j < 4; ++j) { v[j] = v[j] - mean; q += (v[j].x * v[j].x + v[j].y * v[j].y) + (v[j].z * v[j].z + v[j].w * v[j].w); }
                const float rstd = 1.f / sqrtf(wave_sum(q) * (1.f / D) + LN_EPS);
                u32x2* orow = (u32x2*)(HC + (size_t)(b * SEQ + tb0 + F.wave) * D) + F.lane;
#pragma unroll
                for (int j = 0; j < 4; ++j) {
                    const f32x4 y = v[j] * rstd * lg[j] + lb[j];
                    const f32x4 o = y * pg8::sig4(y);
                    u32x2 pw; pw.x = cvt_pk_bf16(o.x, o.y); pw.y = cvt_pk_bf16(o.z, o.w); orow[64 * j] = pw;
                }
            }
        }
    }
    switch (F.wave >> 1) {
        case 0: pool_item<1>(F, WSP(const bf16_t, WS_UP), WSP(bf16_t, WS_PL), b, t0); break;
        case 1: pool_item<2>(F, WSP(const bf16_t, WS_UP), WSP(bf16_t, WS_PL), b, t0); break;
        case 2: pool_item<4>(F, WSP(const bf16_t, WS_UP), WSP(bf16_t, WS_PL), b, t0); break;
        default: pool_item<8>(F, WSP(const bf16_t, WS_UP), WSP(bf16_t, WS_PL), b, t0); break;
    }
    __syncthreads();
}

__global__ void __launch_bounds__(NWAVES * 64, 2) mk_fwd(Args args) {
    extern __shared__ __attribute__((aligned(16))) unsigned char lds_raw[];
    Frame F;
    F.lds = (LAS unsigned char*)lds_raw;
    F.tid = threadIdx.x; F.lane = F.tid & 63; F.wave = __builtin_amdgcn_readfirstlane(F.tid >> 6); F.G = gridDim.x;

    const int lo = args.ph_lo, hi = args.ph_hi;
#ifndef PH_MASK
#define PH_MASK 0x3ff
#endif
#define IN(k) (((PH_MASK >> (k)) & 1) && lo <= (k) && (k) < hi)
#define SEAM(k) do { if (IN(k) && IN((k) + 1)) cg::this_grid().sync(); } while (0)

    if (IN(0)) { p0_prologue(F, args); } SEAM(0);
    if (IN(1)) {
        pg8::Gemm g{WSP(bf16_t, WS_XB), WSP(bf16_t, WS_XB), WSP(bf16_t, WS_WIN), WSP(bf16_t, WS_WIN), D, D, D, 0}; pg8::Order S; S.init(M, DIN, F.G, (int)blockIdx.x, 1);
        pg8::EpiG1 E{WSP(bf16_t, WS_UP), WSP(bf16_t, WS_H), WSP(bf16_t, WS_GP), WSP(bf16_t, WS_GC), WSP(float, WS_BIASP)};
        pg8::gemm_phase<pg8::EpiG1>(F.lds, g, S, E);
    } SEAM(1);
    if (IN(2)) {
        for (int it = blockIdx.x; it < BATCH * 64; it += F.G) thin_item(F, args, it);
    } SEAM(2);
    if (IN(3)) {
        pg8::Gemm g{WSP(bf16_t, WS_PL), WSP(bf16_t, WS_PL), WSP(bf16_t, WS_PW), WSP(bf16_t, WS_PW), D, 256, 256, 256}; pg8::Order S; S.init(M, D, F.G, (int)blockIdx.x, 1);
        pg8::EpiG2a E{WSP(bf16_t, WS_P2), args.in[4]};
        pg8::gemm_phase<pg8::EpiG2a>(F.lds, g, S, E);
    } SEAM(3);
    if (IN(4)) {
        pg8::Gemm g{WSP(bf16_t, WS_P2), WSP(bf16_t, WS_HC), WSP(bf16_t, WS_WPP), WSP(bf16_t, WS_WCP), D, D, D, 0}; pg8::Order S; S.init(M, D, F.G, (int)blockIdx.x, 2);
        pg8::EpiG2b E{WSP(bf16_t, WS_GP), WSP(bf16_t, WS_GC), WSP(bf16_t, WS_MG)};
        pg8::gemm_phase<pg8::EpiG2b>(F.lds, g, S, E);
    } SEAM(4);
    if (IN(5)) {
        pg8::Gemm g{WSP(bf16_t, WS_MG), WSP(bf16_t, WS_MG), WSP(bf16_t, WS_WO), WSP(bf16_t, WS_WO), D, D, D, 0}; pg8::Order S; S.init(M, D, F.G, (int)blockIdx.x, 1);
        pg8::EpiRes E{args.in[0], WSP(float, WS_Z1)};
        pg8::gemm_phase<pg8::EpiRes>(F.lds, g, S, E);
    } SEAM(5);
    if (IN(6)) { ln_rows(F, WSP(float, WS_Z1), WSP(float, WS_Z1), WSP(bf16_t, WS_X1B), args.in[12], args.in[13]); } SEAM(6);
    if (IN(7)) {
        pg8::Gemm g{WSP(bf16_t, WS_X1B), WSP(bf16_t, WS_X1B), WSP(bf16_t, WS_WF1), WSP(bf16_t, WS_WF1), D, D, D, 0}; pg8::Order S; S.init(M, 2 * FF, F.G, (int)blockIdx.x, 1);
        pg8::EpiG4 E{WSP(bf16_t, WS_HID)};
        pg8::gemm_phase<pg8::EpiG4>(F.lds, g, S, E);
    } SEAM(7);
    if (IN(8)) {
        pg8::Gemm g{WSP(bf16_t, WS_HID), WSP(bf16_t, WS_HID), WSP(bf16_t, WS_WF2), WSP(bf16_t, WS_WF2), FF, FF, FF, 0}; pg8::Order S; S.init(M, D, F.G, (int)blockIdx.x, 1);
        pg8::EpiRes E{WSP(float, WS_Z1), args.out};
        pg8::gemm_phase<pg8::EpiRes>(F.lds, g, S, E);
    } SEAM(8);
    if (IN(9)) { ln_rows(F, args.out, args.out, nullptr, args.in[16], args.in[17]); }
#undef IN
#undef SEAM
}

extern "C" void kernel_launch(void* const* d_in, const int* in_sizes, int n_in, void* d_out, int out_size, void* d_ws, size_t ws_size, hipStream_t stream) {
    static int grid = 0;
    if (grid == 0) {
        if (n_in != 18 || in_sizes[0] != M * D || out_size != M * D || ws_size < WS_END) { fprintf(stderr, "kernel_launch: unexpected shapes (n_in %d, in0 %d, out %d, ws %zu); nothing launched\n", n_in, n_in > 0 ? in_sizes[0] : -1, out_size, ws_size); grid = -1; return; }
        int dev = 0, cus = 0, per_cu = 0;
        if (hipGetDevice(&dev) != hipSuccess || hipDeviceGetAttribute(&cus, hipDeviceAttributeMultiprocessorCount, dev) != hipSuccess) { grid = -1; return; }
        if (hipFuncSetAttribute((const void*)mk_fwd, hipFuncAttributeMaxDynamicSharedMemorySize, LDS_BYTES) != hipSuccess) { fprintf(stderr, "kernel_launch: hipFuncSetAttribute failed\n"); grid = -1; return; }
        if (hipOccupancyMaxActiveBlocksPerMultiprocessor(&per_cu, (const void*)mk_fwd, NWAVES * 64, LDS_BYTES) != hipSuccess || per_cu < 1) { fprintf(stderr, "kernel_launch: occupancy query gives %d\n", per_cu); per_cu = 1; }
        (void)hipGetLastError();
        grid = cus * per_cu;
    }
    if (grid < 0) return;
    Args a{};
    for (int i = 0; i < 18; ++i) a.in[i] = (const float*)d_in[i];
    a.out = (float*)d_out; a.ws = (unsigned char*)d_ws;
#if MK_PER_PHASE
    for (int p = 0; p < N_PHASES; ++p) {
        a.ph_lo = p; a.ph_hi = p + 1;
        hipLaunchKernelGGL(mk_fwd, dim3(grid), dim3(NWAVES * 64), LDS_BYTES, stream, a);
    }
#else
    a.ph_lo = 0; a.ph_hi = N_PHASES;
    void* kargs[] = {&a};
    hipError_t e = hipLaunchCooperativeKernel((const void*)mk_fwd, dim3(grid), dim3(NWAVES * 64), kargs, LDS_BYTES, stream);
    if (e != hipSuccess) fprintf(stderr, "kernel_launch: cooperative launch failed: %s (grid %d)\n", hipGetErrorString(e), grid);
#endif
}
```
